# Optimizing an MI355X kernel written in HIP

```python
import math
import jax, jax.numpy as jnp
from jax import lax
import numpy as np

D_MODEL = 1024
BATCH = 16
SEQ = 256
DEPTH = 4
DEC_BATCH = 8
DEC_SEQ = 1024
PAST_LEN = 256

GRID_W = 64
N_HEADS = 16
HEAD_DIM = 64
KV_HEADS = 4
Q_PER_KV = N_HEADS // KV_HEADS
QKV_DIM = (N_HEADS + 2 * KV_HEADS) * HEAD_DIM
WINDOW = 128
BLOCK = 128
ROPE_BASE = 10000.0
ROT_AXIS_DIM = HEAD_DIM // 2
ATTN_SCALE = HEAD_DIM ** -0.5
HY_ORDER = 2
HY_DIRS = 2
FILTER_BANDS = 16
FILTER_EMB = 1 + 2 * FILTER_BANDS
FILTER_HIDDEN = 64
FILTER_FREQ = 1.0
DECAY_FAST_PCT = 0.3
DECAY_SLOW_PCT = 1.5
DECAY_TARGET = 1e-2
D_FF = 2816
N_MOD = 9
LN_EPS = 1e-5
N_ATTN_LAYERS = (DEPTH + 1) // 2
N_HYENA_LAYERS = DEPTH // 2
DEEPNORM_ALPHA = (2 * DEPTH) ** 0.25
DEEPNORM_BETA = (8 * DEPTH) ** -0.25
NEG_INF = -1e30

kernel_name = "hybrid_swa_hyena_macaron_diffusion_step"


def layer_norm(x, g, b):
    xf = x.astype(jnp.float32)
    mu = jnp.mean(xf, -1, keepdims=True)
    var = jnp.mean(jnp.square(xf - mu), -1, keepdims=True)
    return ((xf - mu) * lax.rsqrt(var + LN_EPS) * g + b).astype(x.dtype)


def modulate(x, shift, scale):
    return x * (1 + scale[:, None]) + shift[:, None]


def swiglu(h, w1, w2):
    g, u = jnp.split(h @ w1, 2, axis=-1)
    return (jax.nn.silu(g) * u) @ w2


def grid_positions(L):
    rows = L // GRID_W
    r = jnp.repeat(jnp.arange(rows), GRID_W).astype(jnp.float32)
    c = jnp.tile(jnp.arange(GRID_W), rows).astype(jnp.float32)
    return r, c


def rope_axis(x, pos):
    half = ROT_AXIS_DIM // 2
    inv = ROPE_BASE ** (-jnp.arange(half, dtype=jnp.float32) / half)
    ang = pos[:, None] * inv[None]
    cos = jnp.cos(ang)[None, :, None, :]
    sin = jnp.sin(ang)[None, :, None, :]
    xf = x.astype(jnp.float32)
    x1, x2 = xf[..., :half], xf[..., half:]
    return jnp.concatenate([x1 * cos - x2 * sin, x2 * cos + x1 * sin], -1).astype(x.dtype)


def rope_2d(x):
    r, c = grid_positions(x.shape[1])
    return jnp.concatenate([rope_axis(x[..., :ROT_AXIS_DIM], r), rope_axis(x[..., ROT_AXIS_DIM:], c)], -1)


def split_qkv(h, w_qkv):
    B, L, _ = h.shape
    qkv = h @ w_qkv
    nq, nk = N_HEADS * HEAD_DIM, KV_HEADS * HEAD_DIM
    q = qkv[..., :nq].reshape(B, L, N_HEADS, HEAD_DIM)
    k = qkv[..., nq:nq + nk].reshape(B, L, KV_HEADS, HEAD_DIM)
    v = qkv[..., nq + nk:].reshape(B, L, KV_HEADS, HEAD_DIM)
    return q, k, v


def sink_logits(sink, B, Lq):
    s = sink.astype(jnp.float32).reshape(KV_HEADS, Q_PER_KV)[None, :, :, None, None]
    return jnp.broadcast_to(s, (B, KV_HEADS, Q_PER_KV, Lq, 1))


def attn_context(h, w_qkv, w_o, sink):
    B, L, _ = h.shape
    q, k, v = split_qkv(h, w_qkv)

    def block(b):
        qb = lax.dynamic_slice_in_dim(q, b * BLOCK, BLOCK, axis=1).reshape(B, BLOCK, KV_HEADS, Q_PER_KV, HEAD_DIM)
        s = jnp.einsum('bqkgd,bckd->bkgqc', qb, k).astype(jnp.float32) * ATTN_SCALE
        p = jax.nn.softmax(jnp.concatenate([s, sink_logits(sink, B, BLOCK)], -1), axis=-1)[..., :L]
        o = jnp.einsum('bkgqc,bckd->bqkgd', p.astype(v.dtype), v)
        return o.reshape(B, BLOCK, N_HEADS * HEAD_DIM)

    o = lax.map(block, jnp.arange(L // BLOCK))
    o = jnp.transpose(o, (1, 0, 2, 3)).reshape(B, L, N_HEADS * HEAD_DIM)
    return o @ w_o, k, v


def attn_latent(h, k_ctx, v_ctx, w_qkv, w_o, sink):
    B, L, _ = h.shape
    Lc = k_ctx.shape[1]
    S = BLOCK + 2 * WINDOW
    q, k, v = split_qkv(h, w_qkv)
    q, k = rope_2d(q), rope_2d(k)
    pad = ((0, 0), (WINDOW, WINDOW), (0, 0), (0, 0))
    kp, vp = jnp.pad(k, pad), jnp.pad(v, pad)

    def block(b):
        start = b * BLOCK
        qb = lax.dynamic_slice_in_dim(q, start, BLOCK, axis=1).reshape(B, BLOCK, KV_HEADS, Q_PER_KV, HEAD_DIM)
        kb = lax.dynamic_slice_in_dim(kp, start, S, axis=1)
        vb = lax.dynamic_slice_in_dim(vp, start, S, axis=1)
        qi = start + jnp.arange(BLOCK)
        kj = start - WINDOW + jnp.arange(S)
        valid = (jnp.abs(qi[:, None] - kj[None, :]) <= WINDOW) & (kj >= 0)[None] & (kj < L)[None]
        s_loc = jnp.einsum('bqkgd,bskd->bkgqs', qb, kb).astype(jnp.float32) * ATTN_SCALE
        s_loc = jnp.where(valid, s_loc, NEG_INF)
        s_ctx = jnp.einsum('bqkgd,bckd->bkgqc', qb, k_ctx).astype(jnp.float32) * ATTN_SCALE
        p = jax.nn.softmax(jnp.concatenate([s_loc, s_ctx, sink_logits(sink, B, BLOCK)], -1), axis=-1)
        o = (jnp.einsum('bkgqs,bskd->bqkgd', p[..., :S].astype(vb.dtype), vb)
             + jnp.einsum('bkgqc,bckd->bqkgd', p[..., S:S + Lc].astype(v_ctx.dtype), v_ctx))
        return o.reshape(B, BLOCK, N_HEADS * HEAD_DIM)

    o = lax.map(block, jnp.arange(L // BLOCK))
    o = jnp.transpose(o, (1, 0, 2, 3)).reshape(B, L, N_HEADS * HEAD_DIM)
    return o @ w_o


def short_conv(u, w, b):
    up = jnp.pad(u, ((0, 0), (1, 1), (0, 0)))
    return up[:, :-2] * w[0] + up[:, 1:-1] * w[1] + up[:, 2:] * w[2] + b


def hyena_filter_spectrum(L, f_w1, f_b1, f_w2, f_b2, f_w3):
    t = jnp.arange(L, dtype=jnp.float32) / L
    bands = jnp.arange(1, FILTER_BANDS + 1, dtype=jnp.float32)
    ph = 2 * jnp.pi * t[:, None] * bands[None]
    feats = jnp.concatenate([t[:, None], jnp.sin(ph), jnp.cos(ph)], -1)
    a = jnp.sin(FILTER_FREQ * (feats @ f_w1.astype(jnp.float32) + f_b1.astype(jnp.float32)))
    a = jnp.sin(FILTER_FREQ * (a @ f_w2.astype(jnp.float32) + f_b2.astype(jnp.float32)))
    hf = (a @ f_w3.astype(jnp.float32)).reshape(L, HY_ORDER, HY_DIRS, D_MODEL)
    max_decay = math.log(DECAY_TARGET) / DECAY_FAST_PCT
    min_decay = math.log(DECAY_TARGET) / DECAY_SLOW_PCT
    deltas = jnp.abs(jnp.linspace(min_decay, max_decay, D_MODEL, dtype=jnp.float32))
    hf = hf * jnp.exp(-t[:, None] * deltas[None])[:, None, None, :]
    fwd, bwd = hf[:, :, 0], hf[:, :, 1]
    full = jnp.concatenate([fwd, jnp.zeros((1, HY_ORDER, D_MODEL), jnp.float32), bwd[:0:-1]], axis=0)
    full = full / (jnp.sum(jnp.abs(full), axis=0, keepdims=True) + 1e-6)
    return jnp.fft.rfft(full, axis=0)


def long_conv(z, spec, d):
    L = z.shape[1]
    zf32 = z.astype(jnp.float32)
    zf = jnp.fft.rfft(zf32, n=2 * L, axis=1)
    y = jnp.fft.irfft(zf * spec[None], n=2 * L, axis=1)[:, :L]
    return (y + zf32 * d.astype(jnp.float32)).astype(z.dtype)


def hyena(h, w_in, conv_w, conv_b, f_w1, f_b1, f_w2, f_b2, f_w3, hy_d, w_out):
    L = h.shape[1]
    u = short_conv(h @ w_in, conv_w, conv_b)
    v, x1, x2 = jnp.split(u, 3, axis=-1)
    spec = hyena_filter_spectrum(L, f_w1, f_b1, f_w2, f_b2, f_w3)
    z = x1 * long_conv(v, spec[:, 0], hy_d[0])
    z = x2 * long_conv(z, spec[:, 1], hy_d[1])
    return z @ w_out


def trunk(x, cond, P, ctx_k=None, ctx_v=None):
    new_k, new_v = [], []
    for i in range(DEPTH):
        mod = (jax.nn.silu(cond) @ P['ada_w'][i] + P['ada_b'][i]).reshape(cond.shape[0], N_MOD, D_MODEL)
        h = modulate(x, mod[:, 0], mod[:, 1])
        f = swiglu(h, P['ffn_w1'][i, 0], P['ffn_w2'][i, 0])
        x = layer_norm(DEEPNORM_ALPHA * x + 0.5 * mod[:, 2][:, None] * f, P['ln_g'][i, 0], P['ln_b'][i, 0])
        h = modulate(x, mod[:, 3], mod[:, 4])
        j = i // 2
        if i % 2 == 0:
            if ctx_k is None:
                out, k, v = attn_context(h, P['attn_w_qkv'][j], P['attn_w_o'][j], P['attn_sink'][j])
                new_k.append(k)
                new_v.append(v)
            else:
                out = attn_latent(h, ctx_k[:, j], ctx_v[:, j], P['attn_w_qkv'][j], P['attn_w_o'][j], P['attn_sink'][j])
        else:
            out = hyena(h, P['hy_w_in'][j], P['hy_conv_w'][j], P['hy_conv_b'][j], P['hy_f_w1'][j], P['hy_f_b1'][j],
                        P['hy_f_w2'][j], P['hy_f_b2'][j], P['hy_f_w3'][j], P['hy_d'][j], P['hy_w_out'][j])
        x = layer_norm(DEEPNORM_ALPHA * x + mod[:, 5][:, None] * out, P['ln_g'][i, 1], P['ln_b'][i, 1])
        h = modulate(x, mod[:, 6], mod[:, 7])
        f = swiglu(h, P['ffn_w1'][i, 1], P['ffn_w2'][i, 1])
        x = layer_norm(DEEPNORM_ALPHA * x + 0.5 * mod[:, 8][:, None] * f, P['ln_g'][i, 2], P['ln_b'][i, 2])
    return x, new_k, new_v


def setup_inputs(seed: int = 0) -> dict:
    key = jax.random.key(seed)
    ks = jax.random.split(key, 26)
    f32 = jnp.float32
    nrm = lambda k, shape, s: jax.random.normal(k, shape, f32) * s
    D, A, Hy = D_MODEL, N_ATTN_LAYERS, N_HYENA_LAYERS
    return {
        "x_prompt": nrm(ks[0], (BATCH, SEQ, D), 1.0),
        "x_sample": nrm(ks[1], (DEC_BATCH, DEC_SEQ, D), 1.0),
        "cache_k": nrm(ks[2], (DEC_BATCH, A, PAST_LEN, KV_HEADS, HEAD_DIM), 1.0),
        "cache_v": nrm(ks[3], (DEC_BATCH, A, PAST_LEN, KV_HEADS, HEAD_DIM), 1.0),
        "c": nrm(ks[4], (DEC_BATCH, D), 1.0),
        "c_ctx": nrm(ks[5], (D,), 1.0),
        "ada_w": nrm(ks[6], (DEPTH, D, N_MOD * D), D ** -0.5),
        "ada_b": nrm(ks[7], (DEPTH, N_MOD * D), 0.02),
        "ln_g": 1.0 + nrm(ks[8], (DEPTH, 3, D), 0.02),
        "ln_b": nrm(ks[9], (DEPTH, 3, D), 0.02),
        "ffn_w1": nrm(ks[10], (DEPTH, 2, D, 2 * D_FF), D ** -0.5),
        "ffn_w2": nrm(ks[11], (DEPTH, 2, D_FF, D), D_FF ** -0.5 * DEEPNORM_BETA),
        "attn_w_qkv": nrm(ks[12], (A, D, QKV_DIM), D ** -0.5),
        "attn_w_o": nrm(ks[13], (A, N_HEADS * HEAD_DIM, D), (N_HEADS * HEAD_DIM) ** -0.5 * DEEPNORM_BETA),
        "attn_sink": nrm(ks[14], (A, N_HEADS), 0.5),
        "hy_w_in": nrm(ks[15], (Hy, D, 3 * D), D ** -0.5),
        "hy_conv_w": nrm(ks[16], (Hy, 3, 3 * D), 3 ** -0.5),
        "hy_conv_b": nrm(ks[17], (Hy, 3 * D), 0.02),
        "hy_f_w1": nrm(ks[18], (Hy, FILTER_EMB, FILTER_HIDDEN), FILTER_EMB ** -0.5 * 2.0),
        "hy_f_b1": nrm(ks[19], (Hy, FILTER_HIDDEN), 0.5),
        "hy_f_w2": nrm(ks[20], (Hy, FILTER_HIDDEN, FILTER_HIDDEN), FILTER_HIDDEN ** -0.5 * 2.0),
        "hy_f_b2": nrm(ks[21], (Hy, FILTER_HIDDEN), 0.5),
        "hy_f_w3": nrm(ks[22], (Hy, FILTER_HIDDEN, HY_ORDER * HY_DIRS * D), FILTER_HIDDEN ** -0.5),
        "hy_d": nrm(ks[23], (Hy, HY_ORDER, D), 0.1),
        "hy_w_out": nrm(ks[24], (Hy, D, D), D ** -0.5 * DEEPNORM_BETA),
    }


def reference(x_prompt, x_sample, cache_k, cache_v, c, c_ctx, ada_w, ada_b, ln_g, ln_b, ffn_w1, ffn_w2,
              attn_w_qkv, attn_w_o, attn_sink, hy_w_in, hy_conv_w, hy_conv_b, hy_f_w1, hy_f_b1, hy_f_w2,
              hy_f_b2, hy_f_w3, hy_d, hy_w_out):
    P = {
        'ada_w': ada_w, 'ada_b': ada_b, 'ln_g': ln_g, 'ln_b': ln_b,
        'ffn_w1': ffn_w1, 'ffn_w2': ffn_w2,
        'attn_w_qkv': attn_w_qkv, 'attn_w_o': attn_w_o, 'attn_sink': attn_sink,
        'hy_w_in': hy_w_in, 'hy_conv_w': hy_conv_w, 'hy_conv_b': hy_conv_b,
        'hy_f_w1': hy_f_w1, 'hy_f_b1': hy_f_b1, 'hy_f_w2': hy_f_w2, 'hy_f_b2': hy_f_b2,
        'hy_f_w3': hy_f_w3, 'hy_d': hy_d, 'hy_w_out': hy_w_out,
    }
    y_prompt, ks_list, vs_list = trunk(x_prompt, c_ctx[None], P)
    new_cache_k = jnp.stack(ks_list, axis=1)
    new_cache_v = jnp.stack(vs_list, axis=1)
    y_sample, _, _ = trunk(x_sample, c, P, cache_k, cache_v)
    return (y_prompt, y_sample, new_cache_k, new_cache_v)
```

```cpp
#include <hip/hip_runtime.h>
#include <cstdio>
#include <cstdint>
#include <cmath>
namespace pg8 {
#define PG8_LAS __attribute__((address_space(3)))
typedef unsigned short bf16_t;
typedef short bf16x8 __attribute__((ext_vector_type(8)));
typedef float f32x4 __attribute__((ext_vector_type(4)));
typedef unsigned u32x4 __attribute__((ext_vector_type(4)));
constexpr int BM = 256, BK = 64, HALF = 128, HTB = HALF * BK * 2  , STAGE_BYTES = 8 * HTB, NXCD = 8, WGM = 8;

__host__ __device__ __forceinline__ int lds_byte(int r, int c) { const int st = (r >> 4) * 2 + (c >> 5), rr = r & 15, cc = c & 31, ob = rr * 64 + cc * 2; return st * 1024 + (ob ^ (((ob >> 9) & 1) << 5)); }
__host__ __device__ __forceinline__ void stage_rc(int b, int& R, int& C) { const int st = b / 1024, sb = b % 1024, swz = sb ^ (((sb >> 9) & 1) << 5); R = (st >> 1) * 16 + swz / 64; C = (st & 1) * 32 + (swz % 64) / 2; }
__host__ __device__ __forceinline__ int perm32(int rho) { const int n = rho >> 4, i = rho & 15; return 8 * (i >> 2) + 4 * n + (i & 3); }

struct Unit { int pm, pn; };
struct Gemm { const bf16_t* A; const bf16_t* Bt; int M, N, K; };

struct StaticOrder {
    int nM, nN, nwg, G, c;
    __host__ __device__ void init(int M, int N, int G_, int c_) { nM = M / BM; nN = N / BM; nwg = nM * nN; G = G_; c = c_; }
    __host__ __device__ bool next(int i, Unit& u) const {
        const long L = (long)i * G + c; if (L >= nwg) return false;
        int wgid = (int)L; { const int q = nwg / NXCD, r = nwg % NXCD, xcd = wgid % NXCD, off = wgid / NXCD; wgid = (xcd < r ? xcd * (q + 1) : r * (q + 1) + (xcd - r) * q) + off; }
        const int nig = WGM * nN, gid = wgid / nig, fm = gid * WGM, gsz = (nM - fm) < WGM ? (nM - fm) : WGM;
        u.pm = fm + ((wgid % nig) % gsz); u.pn = (wgid % nig) / gsz; return true;
    }
    __device__ __forceinline__ void a_ready(const Unit&) const {}
    __device__ __forceinline__ void done(const Unit&) const {}
};

__device__ __forceinline__ unsigned cvt_pk_bf16(float lo, float hi) { unsigned r; asm volatile("v_cvt_pk_bf16_f32 %0, %1, %2" : "=v"(r) : "v"(lo), "v"(hi)); return r; }
typedef float f32x2 __attribute__((ext_vector_type(2)));
__device__ __forceinline__ f32x2 gelu_pk(f32x2 v) {
    const f32x2 av = __builtin_elementwise_abs(v), d = av * 0.2316418882f + 1.0f;
    f32x2 t; t.x = __builtin_amdgcn_rcpf(d.x); t.y = __builtin_amdgcn_rcpf(d.y);
    f32x2 q = t * 0.5307027145f + (-0.7265760135f); q = q * t + 0.7107068705f; q = q * t + (-0.142248368f); q = q * t + 0.127414796f; q = q * t;
    const f32x2 s = (v * v) * (-0.72134752044f);
    f32x2 e; e.x = __builtin_amdgcn_exp2f(s.x); e.y = __builtin_amdgcn_exp2f(s.y);
    const f32x2 m = v * (q * e), r = v - m;
    f32x2 o; o.x = v.x < 0.f ? m.x : r.x; o.y = v.y < 0.f ? m.y : r.y; return o;
}

template <int ACT  > struct EpiBf16 {
    static constexpr bool PERM = true, AFTER_DRAIN = false; static_assert(ACT == 0 || ACT == 1, "EpiBf16: ACT is 0 (none) or 1 (gelu_pk)");
    bf16_t* O; int ldc; const float* bias; int split_cols; size_t split_stride; float scale0;
    __device__ __forceinline__ void operator()(const f32x4 (&acc)[2][2][4][2], const Unit& u, int wr, int wc, int fr, int fq) const {
        const int row0 = u.pm * BM + wr * 64 + fr; int colt = u.pn * BM; bf16_t* base = O;
        float sc = 1.f; if (split_cols) { const int t = colt / split_cols; base += (size_t)t * split_stride; colt -= t * split_cols; if (t == 0) sc = scale0; }
        const int col0 = colt + wc * 32 + 8 * fq, bcol0 = u.pn * BM + wc * 32 + 8 * fq;
        f32x4 bv[2][2];
#pragma unroll
        for (int bj = 0; bj < 2; ++bj)
#pragma unroll
            for (int n = 0; n < 2; ++n) bv[bj][n] = bias ? *(const f32x4*)(bias + bcol0 + bj * HALF + 4 * n) : (f32x4){0.f, 0.f, 0.f, 0.f};
#pragma unroll
        for (int ai = 0; ai < 2; ++ai)
#pragma unroll
            for (int m = 0; m < 4; ++m) { bf16_t* rowp = base + (size_t)(row0 + ai * HALF + m * 16) * ldc + col0;
#pragma unroll
                for (int bj = 0; bj < 2; ++bj) { f32x4 v0 = acc[ai][bj][m][0] + bv[bj][0], v1 = acc[ai][bj][m][1] + bv[bj][1];
                    if (ACT == 1) { f32x2 a = gelu_pk((f32x2){v0[0], v0[1]}), b = gelu_pk((f32x2){v0[2], v0[3]}), c = gelu_pk((f32x2){v1[0], v1[1]}), d = gelu_pk((f32x2){v1[2], v1[3]});
                        v0 = (f32x4){a.x, a.y, b.x, b.y}; v1 = (f32x4){c.x, c.y, d.x, d.y}; }
                    v0 = v0 * sc; v1 = v1 * sc; u32x4 w; w.x = cvt_pk_bf16(v0[0], v0[1]); w.y = cvt_pk_bf16(v0[2], v0[3]); w.z = cvt_pk_bf16(v1[0], v1[1]); w.w = cvt_pk_bf16(v1[2], v1[3]);
                    *(u32x4*)(rowp + bj * HALF) = w; } }
    }
};

struct PanelStats {
    unsigned* xbuf;
    unsigned* cnt;
    unsigned* tmo;
    int ntn; float eps;
    unsigned code;
    __device__ __forceinline__ bool run(const f32x4 (&v)[2][2][4][2], const Unit& u, int wr, int wc, int fr, int fq, PG8_LAS unsigned char* lds, int wid, int lane) const {
        typedef float f32x2v __attribute__((ext_vector_type(2)));
        PG8_LAS f32x2v* P = (PG8_LAS f32x2v*)lds;
        PG8_LAS f32x2v* S = (PG8_LAS f32x2v*)(lds + 8192);
        PG8_LAS unsigned* flag = (PG8_LAS unsigned*)(lds + 8192 + 2048);
#pragma unroll
        for (int ai = 0; ai < 2; ++ai)
#pragma unroll
            for (int m = 0; m < 4; ++m) {
                float s = 0.f;
#pragma unroll
                for (int bj = 0; bj < 2; ++bj)
#pragma unroll
                    for (int n = 0; n < 2; ++n) { const f32x4 x = v[ai][bj][m][n]; s += (x[0] + x[1]) + (x[2] + x[3]); }
                s += __shfl_xor(s, 16); s += __shfl_xor(s, 32);
                const float mw = s * (1.0f / 64.0f); float q = 0.f;
#pragma unroll
                for (int bj = 0; bj < 2; ++bj)
#pragma unroll
                    for (int n = 0; n < 2; ++n) { const f32x4 d = v[ai][bj][m][n] - mw; q += (d[0] * d[0] + d[1] * d[1]) + (d[2] * d[2] + d[3] * d[3]); }
                q += __shfl_xor(q, 16); q += __shfl_xor(q, 32);
                if (fq == 0) P[(ai * HALF + wr * 64 + m * 16 + fr) * 4 + wc] = (f32x2v){mw, q};
            }
        asm volatile("s_waitcnt lgkmcnt(0)" ::: "memory"); __builtin_amdgcn_s_barrier(); asm volatile("" ::: "memory");
#if defined(BROKEN_EXCHANGE_NO_WAIT)
#warning BROKEN CONTROL BUILD: the row-statistics exchange does not wait; results are wrong by design
        if (blockIdx.x >= 64) { const long long t0_ = clock64(); while (clock64() - t0_ < 60000) __builtin_amdgcn_s_sleep(8); }
#endif
        const int row = wid * 32 + (lane & 31);
        if (lane < 32) {
            const f32x2v a = P[row * 4 + 0], b = P[row * 4 + 1], c = P[row * 4 + 2], d = P[row * 4 + 3];
            const float mt = (a.x + b.x + c.x + d.x) * 0.25f;
            const float da = a.x - mt, db = b.x - mt, dc = c.x - mt, dd = d.x - mt;
            const float m2 = (a.y + b.y) + (c.y + d.y) + 64.0f * ((da * da + db * db) + (dc * dc + dd * dd));
            unsigned long long* slot = (unsigned long long*)xbuf + ((size_t)(u.pm * BM + row) * 4 + u.pn);
            __hip_atomic_store(slot, ((unsigned long long)__float_as_uint(m2) << 32) | __float_as_uint(mt), __ATOMIC_RELAXED, __HIP_MEMORY_SCOPE_AGENT);
        }
        asm volatile("s_waitcnt vmcnt(0)" ::: "memory");
        if (lane == 0) __hip_atomic_fetch_add(cnt + 64 * u.pm, 1u, __ATOMIC_RELAXED, __HIP_MEMORY_SCOPE_AGENT);
        if (wid == 0) {
            bool dead = false; const unsigned long long t0 = __builtin_amdgcn_s_memrealtime(); const unsigned want = 8u * (unsigned)ntn;
            for (;;) {
#if defined(BROKEN_EXCHANGE_NO_WAIT)
                break;
#endif
                if ((unsigned)__builtin_amdgcn_readfirstlane(__hip_atomic_load(cnt + 64 * u.pm, __ATOMIC_RELAXED, __HIP_MEMORY_SCOPE_AGENT)) >= want) break;
                if (__builtin_amdgcn_s_memrealtime() - t0 > 2000000ull) {
                    if (lane == 0) { unsigned expect = 0u; __hip_atomic_compare_exchange_strong(tmo + 1, &expect, code | (unsigned)(u.pm & 0xff), __ATOMIC_RELAXED, __ATOMIC_RELAXED, __HIP_MEMORY_SCOPE_AGENT);
                                     __hip_atomic_store(tmo, 1u, __ATOMIC_RELAXED, __HIP_MEMORY_SCOPE_AGENT); }
                    dead = true; break; }
                __builtin_amdgcn_s_sleep(2);
            }
            __builtin_amdgcn_fence(__ATOMIC_ACQUIRE, "agent");
            if (lane == 0) flag[0] = dead ? 1u : 0u;
        }
        asm volatile("s_waitcnt vmcnt(0) lgkmcnt(0)" ::: "memory"); __builtin_amdgcn_s_barrier(); asm volatile("" ::: "memory");
        const bool bad = flag[0] != 0u;
        if (lane < 32) {
            const unsigned long long* slot = (const unsigned long long*)xbuf + (size_t)(u.pm * BM + row) * 4; float mt[4], m2[4]; float ms = 0.f;
#pragma unroll
            for (int t = 0; t < 4; ++t) { if (t < ntn) { const unsigned long long w = __hip_atomic_load(slot + t, __ATOMIC_RELAXED, __HIP_MEMORY_SCOPE_AGENT); mt[t] = __uint_as_float((unsigned)w); m2[t] = __uint_as_float((unsigned)(w >> 32)); } else { mt[t] = 0.f; m2[t] = 0.f; } ms += mt[t]; }
            const float mean = ms / (float)ntn; float q = 0.f;
#pragma unroll
            for (int t = 0; t < 4; ++t) if (t < ntn) { const float dm = mt[t] - mean; q += m2[t] + 256.0f * dm * dm; }
            S[row] = (f32x2v){mean, 1.0f / sqrtf(q / (256.0f * (float)ntn) + eps)};
        }
        asm volatile("s_waitcnt lgkmcnt(0)" ::: "memory"); __builtin_amdgcn_s_barrier(); asm volatile("" ::: "memory");
        return bad;
    }
};
struct EpiLnRes {
    static constexpr bool PERM = false, AFTER_DRAIN = true;
    const float* base; float* out; int ldc; const float* bias; PanelStats st; unsigned poison;
    __device__ __forceinline__ void fused(f32x4 (&acc)[2][2][4][2], const Unit& u, int wr, int wc, int fr, int fq, PG8_LAS unsigned char* lds, int wid, int lane) const {
        typedef float f32x2v __attribute__((ext_vector_type(2)));
        const PG8_LAS f32x2v* S = (const PG8_LAS f32x2v*)(lds + 8192);
        const int col0 = u.pn * BM + wc * 32 + 4 * fq;
#pragma unroll
        for (int bj = 0; bj < 2; ++bj)
#pragma unroll
            for (int n = 0; n < 2; ++n) { const f32x4 bv = bias ? *(const f32x4*)(bias + col0 + bj * HALF + n * 16) : (f32x4){0.f, 0.f, 0.f, 0.f};
#pragma unroll
                for (int ai = 0; ai < 2; ++ai)
#pragma unroll
                    for (int m = 0; m < 4; ++m) acc[ai][bj][m][n] += bv; }
        f32x4 pre[4][2][2];
#pragma unroll
        for (int m = 0; m < 4; ++m) { const size_t off = (size_t)(u.pm * BM + wr * 64 + m * 16 + fr) * ldc + col0;
#pragma unroll
            for (int bj = 0; bj < 2; ++bj)
#pragma unroll
                for (int n = 0; n < 2; ++n) pre[m][bj][n] = *(const f32x4*)(base + off + bj * HALF + n * 16); }
        const bool bad = st.run(acc, u, wr, wc, fr, fq, lds, wid, lane) || poison != 0u;
        const float qnan = __builtin_nanf("");
#pragma unroll
        for (int ai = 0; ai < 2; ++ai)
#pragma unroll
            for (int m = 0; m < 4; ++m) { const int r = ai * HALF + wr * 64 + m * 16 + fr; const f32x2v sr = S[r]; const size_t off = (size_t)(u.pm * BM + r) * ldc + col0;
#pragma unroll
                for (int bj = 0; bj < 2; ++bj)
#pragma unroll
                    for (int n = 0; n < 2; ++n) { const f32x4 bs = ai == 0 ? pre[m][bj][n] : *(const f32x4*)(base + off + bj * HALF + n * 16); f32x4 o = bs + (acc[ai][bj][m][n] - sr.x) * sr.y;
                        if (bad) o = (f32x4){qnan, qnan, qnan, qnan}; *(f32x4*)(out + off + bj * HALF + n * 16) = o; }
                if (m & 1) asm volatile("" ::: "memory"); }
    }
};
struct EpiLnResLn {
    static constexpr bool PERM = false, AFTER_DRAIN = true;
    const float* base; float* out; bf16_t* xn; int ldc; const float* bias; PanelStats st1, st2; unsigned poison;
    __device__ __forceinline__ void fused(f32x4 (&acc)[2][2][4][2], const Unit& u, int wr, int wc, int fr, int fq, PG8_LAS unsigned char* lds, int wid, int lane) const {
        typedef float f32x2v __attribute__((ext_vector_type(2))); typedef unsigned u32x2v __attribute__((ext_vector_type(2)));
        const PG8_LAS f32x2v* S = (const PG8_LAS f32x2v*)(lds + 8192);
        const int col0 = u.pn * BM + wc * 32 + 4 * fq;
#pragma unroll
        for (int bj = 0; bj < 2; ++bj)
#pragma unroll
            for (int n = 0; n < 2; ++n) { const f32x4 bv = bias ? *(const f32x4*)(bias + col0 + bj * HALF + n * 16) : (f32x4){0.f, 0.f, 0.f, 0.f};
#pragma unroll
                for (int ai = 0; ai < 2; ++ai)
#pragma unroll
                    for (int m = 0; m < 4; ++m) acc[ai][bj][m][n] += bv; }
        bool bad = st1.run(acc, u, wr, wc, fr, fq, lds, wid, lane) || poison != 0u;
        const float qnan = __builtin_nanf("");
#pragma unroll
        for (int ai = 0; ai < 2; ++ai)
#pragma unroll
            for (int m = 0; m < 4; ++m) { const int r = ai * HALF + wr * 64 + m * 16 + fr; const f32x2v sr = S[r]; const size_t off = (size_t)(u.pm * BM + r) * ldc + col0;
#pragma unroll
                for (int bj = 0; bj < 2; ++bj)
#pragma unroll
                    for (int n = 0; n < 2; ++n) { const f32x4 bs = *(const f32x4*)(base + off + bj * HALF + n * 16); acc[ai][bj][m][n] = bs + (acc[ai][bj][m][n] - sr.x) * sr.y; }
                asm volatile("" : "+v"(acc[ai][0][m][0]), "+v"(acc[ai][0][m][1]), "+v"(acc[ai][1][m][0]), "+v"(acc[ai][1][m][1]));
                if (m & 1) asm volatile("" ::: "memory"); }
        const bool bad1 = bad;
        bad = st2.run(acc, u, wr, wc, fr, fq, lds, wid, lane) || bad;
#pragma unroll
        for (int ai = 0; ai < 2; ++ai)
#pragma unroll
            for (int m = 0; m < 4; ++m) { const int r = ai * HALF + wr * 64 + m * 16 + fr; const f32x2v sr = S[r]; const size_t off = (size_t)(u.pm * BM + r) * ldc + col0;
#pragma unroll
                for (int bj = 0; bj < 2; ++bj)
#pragma unroll
                    for (int n = 0; n < 2; ++n) { const f32x4 x1 = acc[ai][bj][m][n]; *(f32x4*)(out + off + bj * HALF + n * 16) = bad1 ? (f32x4){qnan, qnan, qnan, qnan} : x1;
                        const f32x4 o = (x1 - sr.x) * sr.y; u32x2v w; w.x = cvt_pk_bf16(o[0], o[1]); w.y = cvt_pk_bf16(o[2], o[3]);
                        if (bad) { w.x = 0x7fc07fc0u; w.y = 0x7fc07fc0u; } *(u32x2v*)(xn + off + bj * HALF + n * 16) = w; }
                asm volatile("" ::: "memory"); }
    }
};

template <class Epi, class Sched, bool ALIGN_EPI = false, bool SP2 = false>
__device__ __forceinline__ void gemm_phase(PG8_LAS unsigned char* lds, const Gemm g, const Sched& S, const Epi& E) {
    int tid_raw = threadIdx.x; asm volatile("" : "+v"(tid_raw));
    const int tid = tid_raw, wid = __builtin_amdgcn_readfirstlane(tid >> 6), lane = tid & 63, wr = wid >> 2, wc = wid & 3, fr = lane & 15, fq = lane >> 4;
    const int K = g.K, nt = K / BK;
    unsigned voffA[2], voffB[2];
#pragma unroll
    for (int i = 0; i < 2; ++i) { int R, C; stage_rc(tid * 16 + i * 8192, R, C); const int Rb = Epi::PERM ? ((R & ~31) + perm32(R & 31)) : R;
        voffA[i] = (unsigned)(R * K + C) * 2u; voffB[i] = (unsigned)(Rb * K + C) * 2u; }
    const size_t kstep = (size_t)(BK * 2);
    const size_t hstep = (size_t)HALF * K * 2;
    const size_t tstep = 2 * hstep;
    const unsigned ldsw = (unsigned)wid * 1024u;
    const int aoff = lds_byte(wr * 64 + fr, fq * 8), boff = lds_byte(wc * 32 + fr, fq * 8);
#define PG8_SA(b, h) (((b) * 2 + (h)) * HTB)
#define PG8_SB(b, h) ((4 + (b) * 2 + (h)) * HTB)
#define PG8_STAGE(bufoff, gbase, voff) do { _Pragma("unroll") for (int _i = 0; _i < 2; ++_i) \
        __builtin_amdgcn_global_load_lds((const unsigned*)((const char*)(gbase) + (voff)[_i]), (PG8_LAS unsigned*)(lds + (bufoff) + ldsw + _i * 8192), 16, 0, 0); } while (0)
#define PG8_LDA(dst, b, h) do { _Pragma("unroll") for (int m = 0; m < 4; ++m) _Pragma("unroll") for (int k = 0; k < 2; ++k) dst[m][k] = *(const PG8_LAS bf16x8*)(lds + PG8_SA(b, h) + aoff + m * 2048 + k * 1024); } while (0)
#define PG8_LDB(dst, b, h) do { _Pragma("unroll") for (int n = 0; n < 2; ++n) _Pragma("unroll") for (int k = 0; k < 2; ++k) dst[n][k] = *(const PG8_LAS bf16x8*)(lds + PG8_SB(b, h) + boff + n * 2048 + k * 1024); } while (0)
#define PG8_MMA(ai, bj, At, Bt) do { __builtin_amdgcn_s_setprio(1); _Pragma("unroll") for (int m = 0; m < 4; ++m) _Pragma("unroll") for (int n = 0; n < 2; ++n) _Pragma("unroll") for (int k = 0; k < 2; ++k) \
        acc[ai][bj][m][n] = __builtin_amdgcn_mfma_f32_16x16x32_bf16(Bt[n][k], At[m][k], acc[ai][bj][m][n], 0, 0, 0); __builtin_amdgcn_s_setprio(0); } while (0)
#define PG8_WAIT_V(n) asm volatile("s_waitcnt vmcnt(" #n ")" ::: "memory")
#define PG8_WAIT_L(n) asm volatile("s_waitcnt lgkmcnt(" #n ")" ::: "memory")
#define PG8_BAR __builtin_amdgcn_s_barrier()
#define PG8_SCHED __builtin_amdgcn_sched_barrier(0)
    Unit cur, nxt; int ui = 0;
    if (!S.next(0, cur)) return;
    f32x4 acc[2][2][4][2];
#pragma unroll
    for (int a = 0; a < 2; ++a)
#pragma unroll
        for (int b = 0; b < 2; ++b)
#pragma unroll
            for (int m = 0; m < 4; ++m)
#pragma unroll
                for (int n = 0; n < 2; ++n) acc[a][b][m][n] = (f32x4){0.f, 0.f, 0.f, 0.f};
    bf16x8 At[4][2], B0[2][2], B1[2][2];
    const char* cA = (const char*)g.A + (size_t)cur.pm * tstep; const char* cB = (const char*)g.Bt + (size_t)cur.pn * tstep;
    S.a_ready(cur);
    if constexpr (SP2) {
        PG8_STAGE(PG8_SB(0, 0), cB, voffB); PG8_STAGE(PG8_SB(0, 1), cB + hstep, voffB); PG8_STAGE(PG8_SA(0, 0), cA, voffA); PG8_STAGE(PG8_SA(0, 1), cA + hstep, voffA);
        if (wr == 1) PG8_BAR;
        PG8_WAIT_V(2); PG8_BAR;
        PG8_STAGE(PG8_SB(1, 0), cB + kstep, voffB); PG8_STAGE(PG8_SA(1, 0), cA + kstep, voffA); PG8_STAGE(PG8_SB(1, 1), cB + hstep + kstep, voffB);
        PG8_WAIT_V(6); PG8_BAR;
    } else {
        PG8_STAGE(PG8_SB(0, 0), cB, voffB); PG8_STAGE(PG8_SA(0, 0), cA, voffA); PG8_STAGE(PG8_SB(0, 1), cB + hstep, voffB); PG8_STAGE(PG8_SA(0, 1), cA + hstep, voffA);
        if (wr == 1) PG8_BAR;
        PG8_WAIT_V(4); PG8_BAR;
        PG8_STAGE(PG8_SB(1, 0), cB + kstep, voffB); PG8_STAGE(PG8_SA(1, 0), cA + kstep, voffA); PG8_STAGE(PG8_SB(1, 1), cB + hstep + kstep, voffB);
        PG8_WAIT_V(6); PG8_BAR;
    }
    for (;;) {
        const bool has_next = S.next(ui + 1, nxt);
        const char* nA = has_next ? (const char*)g.A + (size_t)nxt.pm * tstep : cA; const char* nB = has_next ? (const char*)g.Bt + (size_t)nxt.pn * tstep : cB;
        for (int t = 0; t < nt; t += 2) {
            const bool last = (t == nt - 2);
            const char* a1 = cA + (size_t)(t + 1) * kstep;
            const char* a2 = last ? nA : cA + (size_t)(t + 2) * kstep; const char* b2 = last ? nB : cB + (size_t)(t + 2) * kstep;
            const char* a3 = a2 + kstep; const char* b3 = b2 + kstep;
            if (last && has_next) S.a_ready(nxt);
            if constexpr (SP2) {
            PG8_LDB(B0, 0, 0); PG8_LDB(B1, 0, 1); PG8_SCHED; PG8_LDA(At, 0, 0); PG8_STAGE(PG8_SA(1, 1), a1 + hstep, voffA);
            PG8_WAIT_V(8); PG8_WAIT_L(0); PG8_BAR; PG8_MMA(0, 0, At, B0); PG8_MMA(0, 1, At, B1); PG8_BAR; PG8_SCHED;
            PG8_LDA(At, 0, 1); PG8_STAGE(PG8_SB(0, 0), b2, voffB); PG8_STAGE(PG8_SB(0, 1), b2 + hstep, voffB); PG8_STAGE(PG8_SA(0, 0), a2, voffA);
            PG8_WAIT_V(8); PG8_WAIT_L(0); PG8_BAR; PG8_MMA(1, 0, At, B0); PG8_MMA(1, 1, At, B1); PG8_BAR; PG8_SCHED;
            PG8_LDB(B0, 1, 0); PG8_LDB(B1, 1, 1); PG8_SCHED; PG8_LDA(At, 1, 0); PG8_STAGE(PG8_SA(0, 1), a2 + hstep, voffA);
            PG8_WAIT_V(8); PG8_WAIT_L(0); PG8_BAR; PG8_MMA(0, 0, At, B0); PG8_MMA(0, 1, At, B1); PG8_BAR; PG8_SCHED;
            PG8_LDA(At, 1, 1); PG8_STAGE(PG8_SB(1, 0), b3, voffB); PG8_STAGE(PG8_SB(1, 1), b3 + hstep, voffB); PG8_STAGE(PG8_SA(1, 0), a3, voffA);
            PG8_WAIT_V(8); PG8_WAIT_L(0); PG8_BAR; PG8_MMA(1, 0, At, B0); PG8_MMA(1, 1, At, B1); PG8_BAR; PG8_SCHED;
            } else {
            PG8_LDB(B0, 0, 0); PG8_SCHED; PG8_LDA(At, 0, 0); PG8_STAGE(PG8_SA(1, 1), a1 + hstep, voffA);
            PG8_WAIT_L(8); PG8_BAR; PG8_WAIT_L(0); PG8_MMA(0, 0, At, B0); PG8_BAR; PG8_SCHED;
            PG8_LDB(B1, 0, 1); PG8_STAGE(PG8_SB(0, 0), b2, voffB);
            PG8_BAR; PG8_WAIT_L(0); PG8_MMA(0, 1, At, B1); PG8_BAR;
            PG8_LDA(At, 0, 1); PG8_STAGE(PG8_SA(0, 0), a2, voffA);
            PG8_BAR; PG8_WAIT_L(0); PG8_MMA(1, 0, At, B0); PG8_BAR; PG8_SCHED;
            PG8_STAGE(PG8_SB(0, 1), b2 + hstep, voffB);
            PG8_WAIT_V(6); PG8_BAR; PG8_MMA(1, 1, At, B1); PG8_BAR;
            PG8_LDB(B0, 1, 0); PG8_SCHED; PG8_LDA(At, 1, 0); PG8_STAGE(PG8_SA(0, 1), a2 + hstep, voffA);
            PG8_WAIT_L(8); PG8_BAR; PG8_WAIT_L(0); PG8_MMA(0, 0, At, B0); PG8_BAR; PG8_SCHED;
            PG8_LDB(B1, 1, 1); PG8_STAGE(PG8_SB(1, 0), b3, voffB);
            PG8_BAR; PG8_WAIT_L(0); PG8_MMA(0, 1, At, B1); PG8_BAR;
            PG8_LDA(At, 1, 1); PG8_STAGE(PG8_SA(1, 0), a3, voffA);
            PG8_BAR; PG8_WAIT_L(0); PG8_MMA(1, 0, At, B0); PG8_BAR; PG8_SCHED;
            PG8_STAGE(PG8_SB(1, 1), b3 + hstep, voffB);
            PG8_WAIT_V(6); PG8_BAR; PG8_MMA(1, 1, At, B1); PG8_BAR;
            }
        }
        if constexpr (ALIGN_EPI) { if (wr == 0) PG8_BAR; }
        if constexpr (!Epi::AFTER_DRAIN) { E(acc, cur, wr, wc, fr, fq); S.done(cur); }
        if (!has_next) break;
#pragma unroll
        for (int a = 0; a < 2; ++a)
#pragma unroll
            for (int b = 0; b < 2; ++b)
#pragma unroll
                for (int m = 0; m < 4; ++m)
#pragma unroll
                    for (int n = 0; n < 2; ++n) acc[a][b][m][n] = (f32x4){0.f, 0.f, 0.f, 0.f};
        cur = nxt; cA = nA; cB = nB; ++ui;
        if constexpr (ALIGN_EPI) { if (wr == 1) PG8_BAR; }
    }
    PG8_WAIT_V(0);
    if constexpr (!ALIGN_EPI) { if (wr == 0) PG8_BAR; }
    PG8_BAR;
    if constexpr (Epi::AFTER_DRAIN) { E.fused(acc, cur, wr, wc, fr, fq, lds, wid, lane); S.done(cur); }
#undef PG8_SA
#undef PG8_SB
#undef PG8_STAGE
#undef PG8_LDA
#undef PG8_LDB
#undef PG8_MMA
#undef PG8_WAIT_V
#undef PG8_WAIT_L
#undef PG8_BAR
#undef PG8_SCHED
}
}
#define GAS __attribute__((address_space(1)))
#define LAS __attribute__((address_space(3)))
typedef unsigned short bf16;
typedef unsigned v4u __attribute__((ext_vector_type(4)));
typedef float f32x4 __attribute__((ext_vector_type(4)));
typedef short bf16x8 __attribute__((ext_vector_type(8)));
typedef GAS unsigned gu32;
typedef GAS unsigned long long gu64;
#define RLX_AGENT __ATOMIC_RELAXED, __HIP_MEMORY_SCOPE_AGENT
#define LDS_WAIT() asm volatile("s_waitcnt lgkmcnt(0)" ::: "memory")
#define VM_WAIT() asm volatile("s_waitcnt vmcnt(0)" ::: "memory")
__device__ __forceinline__ unsigned long long rt() { return __builtin_amdgcn_s_memrealtime(); }
__device__ __forceinline__ unsigned f2bf(float f) { unsigned u = __builtin_bit_cast(unsigned, f); return (u + 0x7fffu + ((u >> 16) & 1u)) >> 16; }
__device__ __forceinline__ unsigned pk2(float lo, float hi) { return f2bf(lo) | (f2bf(hi) << 16); }

#define XB_TMO      128
#define XB_XCNT(j)  (256  + 64 * (j))
#define XB_XSUB(j)  (1280 + 64 * (j))
#define XB_XGEN(j)  (2304 + 64 * (j))
#define XB_TOP      3328
#define XB_TOPGEN   3392
#define XCD_BAR_WORDS 3456
#define XB_SPIN_CAP (1u << 18)

__device__ __forceinline__ unsigned xb_ld(unsigned* p)              { return __hip_atomic_load(p, __ATOMIC_RELAXED, __HIP_MEMORY_SCOPE_AGENT); }
__device__ __forceinline__ unsigned xb_add(unsigned* p, unsigned v) { return __hip_atomic_fetch_add(p, v, __ATOMIC_RELAXED, __HIP_MEMORY_SCOPE_AGENT); }
__device__ __forceinline__ unsigned xb_xcc_id() { return (unsigned)__builtin_amdgcn_s_getreg((3 << 11) | 20) & 0xFu; }
#define XB_SPIN(cond, bar) do { unsigned _sp = 0; while (cond) { __builtin_amdgcn_s_sleep(1); \
    if ((++_sp & 255u) == 0u) { if (xb_ld(&(bar)[XB_TMO])) break; if (_sp > XB_SPIN_CAP) { atomicAdd(&(bar)[XB_TMO], 1u); break; } } } } while (0)

struct XcdBarrier {
    unsigned* bar; unsigned x;
    volatile LAS unsigned* st;
};

__device__ __forceinline__ XcdBarrier xcd_barrier_post(unsigned* bar, volatile LAS unsigned* st) {
    XcdBarrier b; b.bar = bar; b.x = xb_xcc_id(); b.st = st;
    if (threadIdx.x == 0) (void)xb_add(&bar[XB_XCNT(b.x)], 1u);
    return b;
}
__device__ __forceinline__ void xcd_barrier_complete(unsigned* bar, unsigned x, unsigned& nloc, unsigned& nx) {
    const unsigned G = gridDim.x * gridDim.y * gridDim.z;
    unsigned sum, cnt, mine, sp = 0u;
    for (;;) {
        sum = 0u; cnt = 0u; mine = 0u;
#pragma unroll
        for (unsigned j = 0; j < 16; ++j) { const unsigned c = xb_ld(&bar[XB_XCNT(j)]); sum += c; cnt += (c > 0u) ? 1u : 0u; mine = (j == x) ? c : mine; }
        if (sum == G) break;
        __builtin_amdgcn_s_sleep(1);
        if ((++sp & 255u) == 0u) { if (xb_ld(&bar[XB_TMO])) break; if (sp > XB_SPIN_CAP) { atomicAdd(&bar[XB_TMO], 1u); break; } }
    }
    nloc = mine > 0u ? mine : 1u; nx = cnt > 0u ? cnt : 1u;
}

__device__ __forceinline__ void xcd_barrier(const XcdBarrier& b) {
    asm volatile("s_waitcnt vmcnt(0)" ::: "memory");
    __syncthreads();
    if (threadIdx.x == 0) {
        unsigned* bar = b.bar;
        __builtin_amdgcn_s_waitcnt(0);
        unsigned nloc = b.st[0], nx = b.st[1];
        if (nloc == 0u) { xcd_barrier_complete(bar, b.x, nloc, nx); b.st[0] = nloc; b.st[1] = nx; }
        const unsigned old = xb_add(&bar[XB_XSUB(b.x)], 1u);
        const unsigned gen = old / nloc;
        if (old + 1u == (gen + 1u) * nloc) {
            __builtin_amdgcn_fence(__ATOMIC_RELEASE, "agent");
            asm volatile("s_waitcnt vmcnt(0)" ::: "memory");
            const unsigned og = xb_add(&bar[XB_TOP], 1u);
            const unsigned tg = og / nx;
            if (og + 1u == (tg + 1u) * nx) xb_add(&bar[XB_TOPGEN], 1u);
            else XB_SPIN(xb_ld(&bar[XB_TOPGEN]) == tg, bar);
            __builtin_amdgcn_fence(__ATOMIC_ACQUIRE, "agent");
            xb_add(&bar[XB_XGEN(b.x)], 1u);
            asm volatile("s_waitcnt vmcnt(0)" ::: "memory");
        } else {
            XB_SPIN(xb_ld(&bar[XB_XGEN(b.x)]) == gen, bar);
            __builtin_amdgcn_fence(__ATOMIC_ACQUIRE, "agent");
            asm volatile("s_waitcnt vmcnt(0)" ::: "memory");
        }
    }
    __syncthreads();
}
typedef float f32x16 __attribute__((ext_vector_type(16)));
typedef short s16x4 __attribute__((ext_vector_type(4)));
typedef unsigned u32x2 __attribute__((ext_vector_type(2)));

constexpr int NWAVES = 8, NTHR = 512;
constexpr int D = 1024, DFF = 2816, NFF1 = 5632, NQKV = 1536, NHY = 3072;
constexpr int MROWS = 12288, MCTX = 4096;
constexpr float LN_EPS = 1e-5f;
constexpr float DN_ALPHA = 1.6817928305074290f;
constexpr float LOG2E = 1.4426950408889634f;
constexpr float QSCALE = 0.125f * 1.4426950408889634f;
constexpr float MIN_DECAY = -3.0701134573253945f, MAX_DECAY = -15.350567286626972f;

constexpr size_t MiB = 1u << 20;
constexpr size_t WS_CTL = 0, CTL_ZERO_BYTES = 1 * MiB;
constexpr size_t WS_W1T = 1 * MiB;
constexpr size_t WS_W2T = WS_W1T + 88 * MiB;
constexpr size_t WS_QKVT = WS_W2T + 44 * MiB;
constexpr size_t WS_OT = WS_QKVT + 6 * MiB;
constexpr size_t WS_HIT = WS_OT + 4 * MiB;
constexpr size_t WS_HOT = WS_HIT + 12 * MiB;
constexpr size_t WS_MODP = WS_HOT + 4 * MiB;
constexpr size_t WS_MOD = WS_MODP + 11 * MiB;
constexpr size_t WS_A2 = WS_MOD + 2 * MiB;
constexpr size_t WS_HLIN = WS_A2 + 1 * MiB;
constexpr size_t WS_HSC = WS_HLIN + 20 * MiB;
constexpr size_t WS_X = WS_HSC + 1 * MiB;
constexpr size_t WS_HB = WS_X + 48 * MiB;
constexpr size_t WS_ACT = WS_HB + 24 * MiB;
constexpr size_t WS_F = WS_ACT + 72 * MiB;
constexpr size_t WS_ZT = WS_F + 48 * MiB;
constexpr size_t WS_END = WS_ZT + 24 * MiB;
constexpr int CW_BAR = 4096;

constexpr int RING_BYTES = 131072, LDSCTL_OFF = RING_BYTES, MISC_OFF = LDSCTL_OFF + 320, LDS_BYTES = 147456;

__device__ __forceinline__ float bf2f(bf16 b) { return __builtin_bit_cast(float, (unsigned)b << 16); }
__device__ __forceinline__ float wave_sum(float v) {
#pragma unroll
    for (int o = 1; o < 64; o <<= 1) v += __shfl_xor(v, o);
    return v;
}
__device__ __forceinline__ float silu_f(float g) { return g * __builtin_amdgcn_rcpf(1.f + __expf(-g)); }

struct EpiSwiglu {
    static constexpr bool PERM = true, AFTER_DRAIN = false;
    bf16* O;
    __device__ __forceinline__ void operator()(const pg8::f32x4 (&acc)[2][2][4][2], const pg8::Unit& u, int wr, int wc, int fr, int fq) const {
        const int row0 = u.pm * 256 + wr * 64 + fr, col0 = u.pn * 128 + wc * 32 + 8 * fq;
#pragma unroll
        for (int ai = 0; ai < 2; ++ai)
#pragma unroll
            for (int m = 0; m < 4; ++m) {
                const pg8::f32x4 g0 = acc[ai][0][m][0], g1 = acc[ai][0][m][1], u0 = acc[ai][1][m][0], u1 = acc[ai][1][m][1];
                v4u w;
                w.x = pg8::cvt_pk_bf16(silu_f(g0[0]) * u0[0], silu_f(g0[1]) * u0[1]);
                w.y = pg8::cvt_pk_bf16(silu_f(g0[2]) * u0[2], silu_f(g0[3]) * u0[3]);
                w.z = pg8::cvt_pk_bf16(silu_f(g1[0]) * u1[0], silu_f(g1[1]) * u1[1]);
                w.w = pg8::cvt_pk_bf16(silu_f(g1[2]) * u1[2], silu_f(g1[3]) * u1[3]);
                *(v4u*)(O + (size_t)(row0 + ai * 128 + m * 16) * DFF + col0) = w;
            }
    }
};
struct EpiF32 {
    static constexpr bool PERM = false, AFTER_DRAIN = false;
    float* O; int ldc;
    __device__ __forceinline__ void operator()(const pg8::f32x4 (&acc)[2][2][4][2], const pg8::Unit& u, int wr, int wc, int fr, int fq) const {
        const int row0 = u.pm * 256 + wr * 64 + fr, col0 = u.pn * 256 + wc * 32 + 4 * fq;
#pragma unroll
        for (int ai = 0; ai < 2; ++ai)
#pragma unroll
            for (int m = 0; m < 4; ++m) { float* rp = O + (size_t)(row0 + ai * 128 + m * 16) * ldc + col0;
#pragma unroll
                for (int bj = 0; bj < 2; ++bj)
#pragma unroll
                    for (int n = 0; n < 2; ++n) *(pg8::f32x4*)(rp + bj * 128 + n * 16) = acc[ai][bj][m][n]; }
    }
};
struct EpiQKV {
    static constexpr bool PERM = false, AFTER_DRAIN = false;
    bf16* O; float* ck; float* cv; int j;
    __device__ __forceinline__ void operator()(const pg8::f32x4 (&acc)[2][2][4][2], const pg8::Unit& u, int wr, int wc, int fr, int fq) const {
        const int row0 = u.pm * 256 + wr * 64 + fr;
        const bool lat = u.pm >= 16;
        float inv[4];
#pragma unroll
        for (int e = 0; e < 4; ++e) inv[e] = __builtin_amdgcn_exp2f(-(float)(4 * fq + e) * 0.8304820237218406f);
#pragma unroll
        for (int ai = 0; ai < 2; ++ai)
#pragma unroll
            for (int m = 0; m < 4; ++m) {
                const int row = row0 + ai * 128 + m * 16;
                const int t = lat ? ((row - MCTX) & 1023) : (row & 255);
                const float pos = (wc & 1) ? (float)(t & 63) : (float)(t >> 6);
#pragma unroll
                for (int bj = 0; bj < 2; ++bj) {
                    const int colb = u.pn * 256 + bj * 128 + wc * 32;
                    pg8::f32x4 a0 = acc[ai][bj][m][0], a1 = acc[ai][bj][m][1];
                    if (lat && u.pn < 5) {
#pragma unroll
                        for (int e = 0; e < 4; ++e) { const float ang = pos * inv[e]; const float cs = __cosf(ang), sn = __sinf(ang);
                            const float x1 = a0[e], x2 = a1[e]; a0[e] = x1 * cs - x2 * sn; a1[e] = x2 * cs + x1 * sn; }
                    }
                    if (!lat && u.pn >= 4) {
                        float* dst = (u.pn == 4 ? ck : cv) + (((size_t)(row >> 8) * 2 + j) * 256 + (row & 255)) * 256 + (colb - (u.pn == 4 ? 1024 : 1280)) + 4 * fq;
                        *(pg8::f32x4*)dst = a0; *(pg8::f32x4*)(dst + 16) = a1;
                    }
                    if (u.pn < 4) { a0 = a0 * QSCALE; a1 = a1 * QSCALE; }
                    u32x2 w0, w1; w0.x = pg8::cvt_pk_bf16(a0[0], a0[1]); w0.y = pg8::cvt_pk_bf16(a0[2], a0[3]); w1.x = pg8::cvt_pk_bf16(a1[0], a1[1]); w1.y = pg8::cvt_pk_bf16(a1[2], a1[3]);
                    bf16* op = O + (size_t)row * NQKV + colb + 4 * fq;
                    *(u32x2*)op = w0; *(u32x2*)(op + 16) = w1;
                }
            }
    }
};

struct KArgs { const float* in[25]; float* out; unsigned char* ws; };
#define CAS __attribute__((address_space(4)))
typedef const CAS KArgs* KAp;
#define LAUNDER_S(x) asm volatile("" : "+s"(x))
#define LAUNDER_V(x) asm volatile("" : "+v"(x))

__device__ __forceinline__ void transpose_item(const float* W, int K, int N, bf16* WT, bool perm, LAS float* scr, int item, int lane) {
    const int nblk = N / 32, kb = item / nblk, nb = item % nblk, k0 = 64 * kb, n0 = 32 * nb;
    int drow = n0;
    if (perm) { const int isu = n0 >= DFF ? 1 : 0; const int jj = n0 - isu * DFF; drow = (jj >> 7) * 256 + isu * 128 + (jj & 127); }
#pragma unroll 8
    for (int i = 0; i < 32; ++i) { const int kk = 2 * i + (lane >> 5); scr[kk * 33 + (lane & 31)] = W[(size_t)(k0 + kk) * N + n0 + (lane & 31)]; }
    LDS_WAIT(); asm volatile("" ::: "memory");
    const int c = lane & 7;
#pragma unroll
    for (int jx = 0; jx < 4; ++jx) { const int n = (lane >> 3) + 8 * jx; const LAS float* s = scr + (8 * c) * 33 + n;
        v4u o; o.x = pk2(s[0 * 33], s[1 * 33]); o.y = pk2(s[2 * 33], s[3 * 33]); o.z = pk2(s[4 * 33], s[5 * 33]); o.w = pk2(s[6 * 33], s[7 * 33]);
        *(GAS v4u*)(WT + (size_t)(drow + n) * K + k0 + 8 * c) = o; }
    LDS_WAIT(); asm volatile("" ::: "memory");
}

__device__ __forceinline__ void phase_prologue(KAp a, LAS unsigned char* lds, int G, int tid) {
    LAUNDER_S(a); LAUNDER_V(tid); const int lane = tid & 63, wave = __builtin_amdgcn_readfirstlane(tid >> 6), gw = blockIdx.x * NWAVES + wave, NGW = G * NWAVES;
    unsigned char* ws = a->ws;
    LAS float* scr = (LAS float*)(lds + wave * 16384);
    {
        const float* cc = a->in[4]; const float* cctx = a->in[5]; const float* adaw = a->in[6];
        float* modp = (float*)(ws + WS_MODP);
        for (int it = gw; it < 1152; it += NGW) {
            const int l = it / 288, rem = it % 288, kc = rem / 36, nc = rem % 36, k0 = kc * 128;
            for (int idx = lane; idx < 9 * 128; idx += 64) { const int r = idx >> 7, kk = idx & 127; const float cv = (r == 0) ? cctx[k0 + kk] : cc[(r - 1) * 1024 + k0 + kk]; scr[idx] = cv / (1.f + __expf(-cv)); }
            LDS_WAIT(); asm volatile("" ::: "memory");
            f32x4 acc[9];
#pragma unroll
            for (int r = 0; r < 9; ++r) acc[r] = (f32x4){0.f, 0.f, 0.f, 0.f};
            const float* wp = adaw + ((size_t)l * 1024 + k0) * 9216 + nc * 256 + lane * 4;
#pragma unroll 4
            for (int kk = 0; kk < 128; ++kk) { const f32x4 w = *(const f32x4*)(wp + (size_t)kk * 9216);
#pragma unroll
                for (int r = 0; r < 9; ++r) acc[r] += scr[r * 128 + kk] * w; }
#pragma unroll
            for (int r = 0; r < 9; ++r) *(f32x4*)(modp + ((size_t)(kc * 4 + l) * 9 + r) * 9216 + nc * 256 + lane * 4) = acc[r];
            LDS_WAIT(); asm volatile("" ::: "memory");
        }
    }
    {
        const float* fw1 = a->in[18]; const float* fb1 = a->in[19]; const float* fw2 = a->in[20]; const float* fb2 = a->in[21];
        float* a2g = (float*)(ws + WS_A2);
        for (int it = NGW - 1 - gw; it < 2560; it += NGW) {
            const int j = it / 1280, tt = it % 1280; const int L = tt < 256 ? 256 : 1024, t = tt < 256 ? tt : tt - 256;
            const float tn = (float)t / (float)L;
            const float* w1 = fw1 + (size_t)j * 33 * 64 + lane;
            float s = fb1[j * 64 + lane] + tn * w1[0];
            for (int b = 1; b <= 16; ++b) { const float ph = (6.2831853071795865f * tn) * (float)b; s += sinf(ph) * w1[b * 64] + cosf(ph) * w1[(16 + b) * 64]; }
            const float a1 = sinf(s);
            const float* w2 = fw2 + (size_t)j * 64 * 64 + lane;
            float s2 = fb2[j * 64 + lane];
            for (int k = 0; k < 64; ++k) s2 += __shfl(a1, k) * w2[k * 64];
            a2g[((size_t)j * 1280 + tt) * 64 + lane] = sinf(s2);
        }
    }
    {
        constexpr int I_W1 = 16 * 176, I_W2 = 44 * 32, I_QKV = 16 * 48, I_O = 16 * 32, I_HI = 16 * 96, I_HO = 16 * 32;
        constexpr int N_TR = 8 * I_W1 + 8 * I_W2 + 2 * I_QKV + 2 * I_O + 2 * I_HI + 2 * I_HO;
        for (int it = NGW - 1 - gw; it < N_TR; it += NGW) {
            int r = it;
            if (r < 8 * I_W1) { const int mi = r / I_W1; transpose_item(a->in[10] + (size_t)mi * 1024 * 5632, 1024, 5632, (bf16*)(ws + WS_W1T) + (size_t)mi * 5632 * 1024, true, scr, r % I_W1, lane); continue; } r -= 8 * I_W1;
            if (r < 8 * I_W2) { const int mi = r / I_W2; transpose_item(a->in[11] + (size_t)mi * 2816 * 1024, 2816, 1024, (bf16*)(ws + WS_W2T) + (size_t)mi * 1024 * 2816, false, scr, r % I_W2, lane); continue; } r -= 8 * I_W2;
            if (r < 2 * I_QKV) { const int mi = r / I_QKV; transpose_item(a->in[12] + (size_t)mi * 1024 * 1536, 1024, 1536, (bf16*)(ws + WS_QKVT) + (size_t)mi * 1536 * 1024, false, scr, r % I_QKV, lane); continue; } r -= 2 * I_QKV;
            if (r < 2 * I_O) { const int mi = r / I_O; transpose_item(a->in[13] + (size_t)mi * 1024 * 1024, 1024, 1024, (bf16*)(ws + WS_OT) + (size_t)mi * 1024 * 1024, false, scr, r % I_O, lane); continue; } r -= 2 * I_O;
            if (r < 2 * I_HI) { const int mi = r / I_HI; transpose_item(a->in[15] + (size_t)mi * 1024 * 3072, 1024, 3072, (bf16*)(ws + WS_HIT) + (size_t)mi * 3072 * 1024, false, scr, r % I_HI, lane); continue; } r -= 2 * I_HI;
            { const int mi = r / I_HO; transpose_item(a->in[24] + (size_t)mi * 1024 * 1024, 1024, 1024, (bf16*)(ws + WS_HOT) + (size_t)mi * 1024 * 1024, false, scr, r % I_HO, lane); }
        }
    }
}

__device__ __forceinline__ void phase_mod_filters(KAp a, LAS unsigned char* lds, int G, int tid) {
    LAUNDER_S(a); LAUNDER_V(tid); const int lane = tid & 63, wave = __builtin_amdgcn_readfirstlane(tid >> 6);
    unsigned char* ws = a->ws;
    {
        const float* adab = a->in[7]; const float* modp = (const float*)(ws + WS_MODP); float* mod = (float*)(ws + WS_MOD);
        for (int idx = blockIdx.x * NTHR + tid; idx < 331776; idx += G * NTHR) { const int l = idx / 82944, n = idx % 9216; float s = adab[l * 9216 + n];
#pragma unroll
            for (int kc = 0; kc < 8; ++kc) s += modp[(size_t)kc * 331776 + idx];
            mod[idx] = s; }
    }
    const float* fw3 = a->in[22]; const float* a2g = (const float*)(ws + WS_A2); bf16* hlin = (bf16*)(ws + WS_HLIN); float* hsc = (float*)(ws + WS_HSC);
    LAS float* w3s = (LAS float*)lds;
    LAS float* psum = (LAS float*)(lds + 16384);
    for (int u = blockIdx.x; u < 256; u += G) {
        const int pass = u & 1, o = (u >> 1) & 1, j = (u >> 2) & 1, chunk = u >> 3;
        const int L = pass ? 1024 : 256, toff = pass ? 256 : 0, c0 = chunk * 32;
        __syncthreads();
        for (int idx = tid; idx < 4096; idx += NTHR) { const int ch = idx & 31, dir = (idx >> 5) & 1, k = idx >> 6;
            w3s[(dir * 32 + ch) * 64 + k] = fw3[((size_t)j * 64 + k) * 4096 + (o * 2 + dir) * 1024 + c0 + ch]; }
        __syncthreads();
        bf16* hbase = hlin + (size_t)j * 5 * 1048576 + (pass ? 1048576 : 0) + (size_t)(o * 1024 + c0) * (2 * L);
        const int nit = pass ? 2 : 1;
        for (int itn = 0; itn < nit; ++itn) {
            const int t = itn * NTHR + tid; const bool act = t < L;
            float av[64];
            { const f32x4* ap = (const f32x4*)(a2g + ((size_t)j * 1280 + toff + (act ? t : 0)) * 64);
#pragma unroll
              for (int q = 0; q < 16; ++q) { const f32x4 v = ap[q]; av[4 * q] = v.x; av[4 * q + 1] = v.y; av[4 * q + 2] = v.z; av[4 * q + 3] = v.w; } }
            const float tn = (float)t / (float)L;
            for (int ch = 0; ch < 32; ++ch) {
                float d0 = 0.f, d1 = 0.f;
#pragma unroll
                for (int q = 0; q < 16; ++q) { const f32x4 wa = *(const LAS f32x4*)(w3s + ch * 64 + 4 * q), wb = *(const LAS f32x4*)(w3s + (32 + ch) * 64 + 4 * q);
                    d0 += av[4 * q] * wa.x + av[4 * q + 1] * wa.y + av[4 * q + 2] * wa.z + av[4 * q + 3] * wa.w;
                    d1 += av[4 * q] * wb.x + av[4 * q + 1] * wb.y + av[4 * q + 2] * wb.z + av[4 * q + 3] * wb.w; }
                const float delta = fabsf(MIN_DECAY + (MAX_DECAY - MIN_DECAY) * ((float)(c0 + ch) / 1023.f));
                const float win = __expf(-tn * delta);
                const float vf = d0 * win, vb = d1 * win;
                float ab = 0.f;
                if (act) { bf16* hp = hbase + (size_t)ch * (2 * L); hp[L + t] = (bf16)f2bf(vf); ab = fabsf(vf);
                    if (t > 0) { hp[L - t] = (bf16)f2bf(vb); ab += fabsf(vb); } else hp[0] = 0; }
                ab = wave_sum(ab);
                if (lane == 0) psum[(itn * 8 + wave) * 32 + ch] = ab;
            }
        }
        __syncthreads();
        if (tid < 32) { float s = 0.f; for (int i = 0; i < nit * 8; ++i) s += psum[i * 32 + tid]; hsc[((j * 2 + pass) * 2 + o) * 1024 + c0 + tid] = 1.f / (s + 1e-6f); }
    }
}

__device__ __forceinline__ int cond_row(int row) { return row < MCTX ? 0 : 1 + ((row - MCTX) >> 10); }

__device__ __forceinline__ void phase_init(KAp a, int G, int tid) {
    LAUNDER_S(a); LAUNDER_V(tid); const int lane = tid & 63, wave = __builtin_amdgcn_readfirstlane(tid >> 6), gw = blockIdx.x * NWAVES + wave, NGW = G * NWAVES;
    unsigned char* ws = a->ws; float* X = (float*)(ws + WS_X); bf16* Hb = (bf16*)(ws + WS_HB); const float* mod = (const float*)(ws + WS_MOD);
    for (int row = gw; row < MROWS; row += NGW) {
        const int r = cond_row(row);
        const float* xr = row < MCTX ? a->in[0] + (size_t)row * D : a->in[1] + (size_t)(row - MCTX) * D;
        const float* sh = mod + (size_t)(r * 9 + 0) * 1024; const float* sc = sh + 1024;
#pragma unroll
        for (int jx = 0; jx < 4; ++jx) { const int col = 4 * lane + 256 * jx;
            const f32x4 xv = *(const f32x4*)(xr + col), s1 = *(const f32x4*)(sc + col), s0 = *(const f32x4*)(sh + col);
            *(f32x4*)(X + (size_t)row * D + col) = xv;
            const f32x4 h = xv * (1.f + s1) + s0;
            u32x2 w; w.x = pk2(h.x, h.y); w.y = pk2(h.z, h.w); *(u32x2*)(Hb + (size_t)row * D + col) = w; }
    }
}

__device__ __forceinline__ void phase_ln(KAp a, int l, int gi, float gs, int lnidx, int nl, int si, bool to_out, int G, int tid) {
    LAUNDER_S(a); LAUNDER_V(tid); const int lane = tid & 63, wave = __builtin_amdgcn_readfirstlane(tid >> 6), gw = blockIdx.x * NWAVES + wave, NGW = G * NWAVES;
    float* dst = to_out ? a->out : (float*)(a->ws + WS_X);
    unsigned char* ws = a->ws; const float* X = (const float*)(ws + WS_X); const float* F = (const float*)(ws + WS_F); bf16* Hb = (bf16*)(ws + WS_HB); const float* mod = (const float*)(ws + WS_MOD);
    const float* lng = a->in[8] + (size_t)lnidx * D; const float* lnb = a->in[9] + (size_t)lnidx * D;
    for (int row = gw; row < MROWS; row += NGW) {
        const int r = cond_row(row);
        const float* gate = mod + ((size_t)(l * 9 + r) * 9 + gi) * 1024;
        const float* xr = X + (size_t)row * D; const float* fr = F + (size_t)row * D;
        f32x4 y[4]; float s = 0.f;
#pragma unroll
        for (int jx = 0; jx < 4; ++jx) { const int col = 4 * lane + 256 * jx;
            const f32x4 xv = *(const f32x4*)(xr + col), fv = *(const f32x4*)(fr + col), gv = *(const f32x4*)(gate + col);
            y[jx] = DN_ALPHA * xv + gs * (gv * fv); s += (y[jx].x + y[jx].y) + (y[jx].z + y[jx].w); }
        const float mean = wave_sum(s) * (1.f / D); float s2 = 0.f;
#pragma unroll
        for (int jx = 0; jx < 4; ++jx) { y[jx] = y[jx] - mean; s2 += (y[jx].x * y[jx].x + y[jx].y * y[jx].y) + (y[jx].z * y[jx].z + y[jx].w * y[jx].w); }
        const float rstd = 1.f / sqrtf(wave_sum(s2) * (1.f / D) + LN_EPS);
        const float* sh = nl >= 0 ? mod + ((size_t)(nl * 9 + r) * 9 + si) * 1024 : mod; const float* sc = sh + 1024;
#pragma unroll
        for (int jx = 0; jx < 4; ++jx) { const int col = 4 * lane + 256 * jx;
            const f32x4 g = *(const f32x4*)(lng + col), b = *(const f32x4*)(lnb + col);
            const f32x4 xn = y[jx] * rstd * g + b;
            *(f32x4*)(dst + (size_t)row * D + col) = xn;
            if (nl >= 0) { const f32x4 s1 = *(const f32x4*)(sc + col), s0 = *(const f32x4*)(sh + col); const f32x4 h = xn * (1.f + s1) + s0;
                u32x2 w; w.x = pk2(h.x, h.y); w.y = pk2(h.z, h.w); *(u32x2*)(Hb + (size_t)row * D + col) = w; } }
    }
}

__device__ __forceinline__ int crow(int r, int hi) { return (r & 3) + 8 * (r >> 2) + 4 * hi; }
__device__ __forceinline__ void phase_attn(KAp a, int j, LAS unsigned char* lds, int G, int tid) {
    LAUNDER_S(a); LAUNDER_V(tid); const int lane = tid & 63, wave = __builtin_amdgcn_readfirstlane(tid >> 6);
    unsigned char* ws = a->ws; const bf16* qkv = (const bf16*)(ws + WS_ACT); bf16* Ob = (bf16*)(ws + WS_HB);
    const float* cache_k = a->in[2]; const float* cache_v = a->in[3]; const float* sink = a->in[14] + j * 16;
    LAS bf16* Ks = (LAS bf16*)lds; LAS bf16* Vt = (LAS bf16*)(lds + 9216);
    const int hi = lane >> 5, l32 = lane & 31;
    for (int u = blockIdx.x; u < 768; u += G) {
        const bool lat = u < 512;
        int b, kvh, qb, L, rowbase;
        if (lat) { b = u >> 6; kvh = (u >> 4) & 3; qb = u & 15; L = 1024; rowbase = MCTX + b * 1024; }
        else { const int v = u - 512; b = v >> 4; kvh = (v >> 2) & 3; qb = v & 3; L = 256; rowbase = b * 256; }
        const int q0 = qb * 64, head = kvh * 4 + (wave & 3), qs = q0 + (wave >> 2) * 32;
        bf16x8 qf[4];
#pragma unroll
        for (int kb = 0; kb < 4; ++kb) qf[kb] = *(const bf16x8*)(qkv + (size_t)(rowbase + qs + l32) * NQKV + head * 64 + 16 * kb + 8 * hi);
        float mrun = sink[head] * LOG2E, lsum = 1.f;
        f32x16 o0, o1;
#pragma unroll
        for (int r = 0; r < 16; ++r) { o0[r] = 0.f; o1[r] = 0.f; }
        const int nch = lat ? 9 : 4;
        for (int ci = 0; ci < nch; ++ci) {
            int kstart; bool local = false, cache = false;
            if (lat) { if (ci < 5) { kstart = q0 - 128 + 64 * ci; if (kstart < 0 || kstart >= L) continue; local = true; } else { kstart = 64 * (ci - 5); cache = true; } }
            else kstart = 64 * ci;
            __syncthreads();
            {
                const int key = tid & 63, dg = tid >> 6;
                bf16x8 kv8, vv8;
                if (cache) {
                    const size_t off = ((((size_t)b * 2 + j) * 256 + kstart + key) * 4 + kvh) * 64 + dg * 8;
                    const f32x4 k0 = *(const f32x4*)(cache_k + off), k1 = *(const f32x4*)(cache_k + off + 4), v0 = *(const f32x4*)(cache_v + off), v1 = *(const f32x4*)(cache_v + off + 4);
                    v4u kk, vv; kk.x = pk2(k0.x, k0.y); kk.y = pk2(k0.z, k0.w); kk.z = pk2(k1.x, k1.y); kk.w = pk2(k1.z, k1.w);
                    vv.x = pk2(v0.x, v0.y); vv.y = pk2(v0.z, v0.w); vv.z = pk2(v1.x, v1.y); vv.w = pk2(v1.z, v1.w);
                    kv8 = __builtin_bit_cast(bf16x8, kk); vv8 = __builtin_bit_cast(bf16x8, vv);
                } else {
                    const bf16* kp = qkv + (size_t)(rowbase + kstart + key) * NQKV + 1024 + kvh * 64 + dg * 8;
                    kv8 = *(const bf16x8*)kp; vv8 = *(const bf16x8*)(kp + 256);
                }
                *(LAS bf16x8*)(Ks + key * 72 + dg * 8) = kv8;
#pragma unroll
                for (int e = 0; e < 8; ++e) Vt[(dg * 8 + e) * 72 + key] = (bf16)vv8[e];
            }
            __syncthreads();
            f32x16 p0, p1;
#pragma unroll
            for (int r = 0; r < 16; ++r) { p0[r] = 0.f; p1[r] = 0.f; }
#pragma unroll
            for (int kb = 0; kb < 4; ++kb) {
                const bf16x8 k0f = *(const LAS bf16x8*)(Ks + l32 * 72 + 16 * kb + 8 * hi), k1f = *(const LAS bf16x8*)(Ks + (32 + l32) * 72 + 16 * kb + 8 * hi);
                p0 = __builtin_amdgcn_mfma_f32_32x32x16_bf16(k0f, qf[kb], p0, 0, 0, 0);
                p1 = __builtin_amdgcn_mfma_f32_32x32x16_bf16(k1f, qf[kb], p1, 0, 0, 0);
            }
            if (local) { const int qi = qs + l32;
#pragma unroll
                for (int r = 0; r < 16; ++r) { const int d0 = qi - (kstart + crow(r, hi)); if (d0 > 128 || d0 < -128) p0[r] = -INFINITY; const int d1 = d0 - 32; if (d1 > 128 || d1 < -128) p1[r] = -INFINITY; } }
            float mx = fmaxf(p0[0], p1[0]);
#pragma unroll
            for (int r = 1; r < 16; ++r) mx = fmaxf(mx, fmaxf(p0[r], p1[r]));
            mx = fmaxf(mx, __shfl_xor(mx, 32));
            const float mnew = fmaxf(mrun, mx), alpha = __builtin_amdgcn_exp2f(mrun - mnew); mrun = mnew;
            float ps = 0.f;
#pragma unroll
            for (int r = 0; r < 16; ++r) { p0[r] = __builtin_amdgcn_exp2f(p0[r] - mnew); p1[r] = __builtin_amdgcn_exp2f(p1[r] - mnew); ps += p0[r] + p1[r]; }
            ps += __shfl_xor(ps, 32);
            lsum = lsum * alpha + ps;
#pragma unroll
            for (int r = 0; r < 16; ++r) { o0[r] *= alpha; o1[r] *= alpha; }
#pragma unroll
            for (int kb2 = 0; kb2 < 4; ++kb2) {
                v4u pw;
                if (kb2 == 0) { pw.x = pk2(p0[0], p0[1]); pw.y = pk2(p0[2], p0[3]); pw.z = pk2(p0[4], p0[5]); pw.w = pk2(p0[6], p0[7]); }
                else if (kb2 == 1) { pw.x = pk2(p0[8], p0[9]); pw.y = pk2(p0[10], p0[11]); pw.z = pk2(p0[12], p0[13]); pw.w = pk2(p0[14], p0[15]); }
                else if (kb2 == 2) { pw.x = pk2(p1[0], p1[1]); pw.y = pk2(p1[2], p1[3]); pw.z = pk2(p1[4], p1[5]); pw.w = pk2(p1[6], p1[7]); }
                else { pw.x = pk2(p1[8], p1[9]); pw.y = pk2(p1[10], p1[11]); pw.z = pk2(p1[12], p1[13]); pw.w = pk2(p1[14], p1[15]); }
                const bf16x8 pf = __builtin_bit_cast(bf16x8, pw);
                const int kbase = 16 * kb2;
                { const s16x4 lo = *(const LAS s16x4*)(Vt + l32 * 72 + kbase + 4 * hi), hh = *(const LAS s16x4*)(Vt + l32 * 72 + kbase + 8 + 4 * hi);
                  const bf16x8 vf = {lo[0], lo[1], lo[2], lo[3], hh[0], hh[1], hh[2], hh[3]};
                  o0 = __builtin_amdgcn_mfma_f32_32x32x16_bf16(vf, pf, o0, 0, 0, 0); }
                { const s16x4 lo = *(const LAS s16x4*)(Vt + (32 + l32) * 72 + kbase + 4 * hi), hh = *(const LAS s16x4*)(Vt + (32 + l32) * 72 + kbase + 8 + 4 * hi);
                  const bf16x8 vf = {lo[0], lo[1], lo[2], lo[3], hh[0], hh[1], hh[2], hh[3]};
                  o1 = __builtin_amdgcn_mfma_f32_32x32x16_bf16(vf, pf, o1, 0, 0, 0); }
            }
        }
        const float invl = 1.f / lsum;
        bf16* op = Ob + (size_t)(rowbase + qs + l32) * D + head * 64 + 4 * hi;
#pragma unroll
        for (int rg = 0; rg < 4; ++rg) {
            u32x2 w0, w1;
            w0.x = pk2(o0[4 * rg] * invl, o0[4 * rg + 1] * invl); w0.y = pk2(o0[4 * rg + 2] * invl, o0[4 * rg + 3] * invl);
            w1.x = pk2(o1[4 * rg] * invl, o1[4 * rg + 1] * invl); w1.y = pk2(o1[4 * rg + 2] * invl, o1[4 * rg + 3] * invl);
            *(u32x2*)(op + 8 * rg) = w0; *(u32x2*)(op + 32 + 8 * rg) = w1;
        }
    }
}

constexpr int HY_HV = 0, HY_XP = 33792, HY_X1 = 51200, HY_X2 = 67584, HY_R = 83968, HY_HL = 100416;
template <bool LAT>
__device__ __forceinline__ void hyena_unit(KAp a, int j, int c, LAS unsigned char* lds, int tid, int wave, int lane) {
    constexpr int L = LAT ? 1024 : 256, NB = LAT ? 8 : 16, XS = L + 56, NT = LAT ? 4 : 2, TS = LAT ? 32 : 16, J0 = LAT ? 0 : 1, J1 = LAT ? 33 : 9, OFF = L + 8, NE = 2 * L + 32;
    constexpr int rowbase = LAT ? MCTX : 0, nrows = NB * L, pass = LAT ? 1 : 0;
    unsigned char* ws = a->ws;
    const bf16* uT = (const bf16*)(ws + WS_ACT); bf16* zT = (bf16*)(ws + WS_ZT);
    const bf16* hlin = (const bf16*)(ws + WS_HLIN); const float* hsc = (const float*)(ws + WS_HSC);
    const float* cw = a->in[16] + (size_t)j * 3 * NHY; const float* cb = a->in[17] + (size_t)j * NHY; const float* hd = a->in[23] + (size_t)j * 2 * D;
    LAS bf16* HV = (LAS bf16*)(lds + HY_HV); LAS bf16* XP = (LAS bf16*)(lds + HY_XP); LAS bf16* X1 = (LAS bf16*)(lds + HY_X1); LAS bf16* X2 = (LAS bf16*)(lds + HY_X2);
    LAS bf16* R = (LAS bf16*)(lds + HY_R); LAS bf16* HL = (LAS bf16*)(lds + HY_HL);
    __syncthreads();
    for (int i = tid; i < NB * 56; i += NTHR) { const int b = i / 56, p = i % 56; XP[b * XS + (p < 32 ? p : L + p)] = 0; }
#pragma unroll 1
    for (int part = 0; part < 3; ++part) {
        const bf16* src = uT + (size_t)(part * 1024 + c) * MROWS + rowbase;
        for (int i = tid * 8; i < nrows; i += NTHR * 8) *(LAS bf16x8*)(R + 8 + i) = *(const bf16x8*)(src + i);
        __syncthreads();
        const float w0 = cw[0 * NHY + part * 1024 + c], w1 = cw[1 * NHY + part * 1024 + c], w2 = cw[2 * NHY + part * 1024 + c], bias = cb[part * 1024 + c];
        for (int i = tid; i < nrows; i += NTHR) { const int b = i / L, t = i % L;
            const float xm = t > 0 ? bf2f(R[8 + i - 1]) : 0.f, x0 = bf2f(R[8 + i]), xp = t < L - 1 ? bf2f(R[8 + i + 1]) : 0.f;
            const bf16 v = (bf16)f2bf(xm * w0 + x0 * w1 + xp * w2 + bias);
            if (part == 0) XP[b * XS + 32 + t] = v; else if (part == 1) X1[i] = v; else X2[i] = v; }
        __syncthreads();
    }
    const int n = lane & 15, kq = lane >> 4;
    const int brow = LAT ? (n & 7) : n, tau16 = LAT ? 16 * (n >> 3) : 0;
#pragma unroll 1
    for (int o = 0; o < 2; ++o) {
        const bf16* hsrc = hlin + (size_t)j * 5 * 1048576 + (LAT ? 1048576 : 0) + (size_t)(o * 1024 + c) * (2 * L);
        for (int i = tid * 8; i < 2 * L; i += NTHR * 8) *(LAS bf16x8*)(HL + i) = *(const bf16x8*)(hsrc + i);
        __syncthreads();
        for (int e = tid; e < NE; e += NTHR) {
            bf16x8 hv;
#pragma unroll
            for (int jj = 0; jj < 8; ++jj) { const int k = e - OFF - jj; hv[jj] = (k >= -L && k < L) ? (short)HL[k + L] : (short)0; }
            *(LAS bf16x8*)(HV + e * 8) = hv;
        }
        __syncthreads();
        f32x4 acc[NT];
#pragma unroll
        for (int i = 0; i < NT; ++i) acc[i] = (f32x4){0.f, 0.f, 0.f, 0.f};
        const int tw = wave * NT * TS;
        const LAS bf16* bp = XP + brow * XS + 32 + 8 * kq + tau16;
        const int abase = n - 8 * kq + OFF;
        bf16x8 af[NT];
#pragma unroll 1
        for (int js = J0; js < J1; ++js) {
            const int s0 = 32 * js - 32;
            const bf16x8 bfrag = *(const LAS bf16x8*)(bp + s0);
            if (LAT && js > J0) {
#pragma unroll
                for (int i = NT - 1; i > 0; --i) af[i] = af[i - 1];
                af[0] = *(const LAS bf16x8*)(HV + (abase + tw - s0) * 8);
            } else {
#pragma unroll
                for (int i = 0; i < NT; ++i) af[i] = *(const LAS bf16x8*)(HV + (abase + tw + i * TS - s0) * 8);
            }
#pragma unroll
            for (int i = 0; i < NT; ++i) acc[i] = __builtin_amdgcn_mfma_f32_16x16x32_bf16(af[i], bfrag, acc[i], 0, 0, 0);
        }
        const float sc = hsc[((j * 2 + pass) * 2 + o) * 1024 + c], dd = hd[o * D + c];
        __syncthreads();
        const LAS bf16* gatep = o == 0 ? X1 : X2;
#pragma unroll
        for (int i = 0; i < NT; ++i) {
            const int tout = tw + i * TS + 4 * kq + tau16;
            LAS bf16* xp = XP + brow * XS + 32 + tout;
            const u32x2 xin = *(const LAS u32x2*)xp, gv = *(const LAS u32x2*)(gatep + brow * L + tout);
            const float x0 = __builtin_bit_cast(float, xin.x << 16), x1 = __builtin_bit_cast(float, xin.x & 0xffff0000u), x2 = __builtin_bit_cast(float, xin.y << 16), x3 = __builtin_bit_cast(float, xin.y & 0xffff0000u);
            const float g0 = __builtin_bit_cast(float, gv.x << 16), g1 = __builtin_bit_cast(float, gv.x & 0xffff0000u), g2 = __builtin_bit_cast(float, gv.y << 16), g3 = __builtin_bit_cast(float, gv.y & 0xffff0000u);
            const float z0 = g0 * (sc * acc[i][0] + dd * x0), z1 = g1 * (sc * acc[i][1] + dd * x1), z2 = g2 * (sc * acc[i][2] + dd * x2), z3 = g3 * (sc * acc[i][3] + dd * x3);
            u32x2 w; w.x = pk2(z0, z1); w.y = pk2(z2, z3);
            if (o == 0) *(LAS u32x2*)xp = w;
            else *(u32x2*)(zT + (size_t)c * MROWS + rowbase + brow * L + tout) = w;
        }
        __syncthreads();
    }
}
__device__ __forceinline__ void phase_hyena(KAp a, int j, LAS unsigned char* lds, int G, int tid) {
    LAUNDER_S(a); LAUNDER_V(tid); const int lane = tid & 63, wave = __builtin_amdgcn_readfirstlane(tid >> 6);
    for (int u = blockIdx.x; u < 2048; u += G) {
        if (u < 1024) hyena_unit<true>(a, j, u, lds, tid, wave, lane);
        else hyena_unit<false>(a, j, u - 1024, lds, tid, wave, lane);
    }
}
__device__ __forceinline__ void phase_transpose(KAp a, LAS unsigned char* lds, int G, int tid) {
    LAUNDER_S(a); LAUNDER_V(tid); const int lane = tid & 63, wave = __builtin_amdgcn_readfirstlane(tid >> 6), gw = blockIdx.x * NWAVES + wave, NGW = G * NWAVES;
    unsigned char* ws = a->ws; const bf16* zT = (const bf16*)(ws + WS_ZT); bf16* Hb = (bf16*)(ws + WS_HB);
    LAS bf16* T = (LAS bf16*)(lds + wave * 16384);
    for (int it = gw; it < 16 * 192; it += NGW) {
        const int c0 = (it & 15) * 64, r0 = (it >> 4) * 64;
#pragma unroll
        for (int i = 0; i < 8; ++i) { const bf16x8 v = *(const bf16x8*)(zT + (size_t)(c0 + lane) * MROWS + r0 + 8 * i);
#pragma unroll
            for (int e = 0; e < 8; ++e) T[(8 * i + e) * 72 + lane] = (bf16)v[e]; }
        LDS_WAIT(); asm volatile("" ::: "memory");
#pragma unroll
        for (int i = 0; i < 8; ++i) *(bf16x8*)(Hb + (size_t)(r0 + lane) * D + c0 + 8 * i) = *(const LAS bf16x8*)(T + lane * 72 + 8 * i);
        LDS_WAIT(); asm volatile("" ::: "memory");
    }
}

template <class Epi>
__device__ __forceinline__ void run_gemm(LAS unsigned char* lds, const bf16* A, const bf16* Bt, int M, int N, int K, int G, const Epi& E) {
    pg8::Gemm g{A, Bt, M, N, K}; pg8::StaticOrder S; S.init(M, N, G, (int)blockIdx.x);
    pg8::gemm_phase<Epi, pg8::StaticOrder, true, true>(lds, g, S, E);
}
__global__ void __launch_bounds__(NWAVES * 64, 2) fwd_megakernel(KArgs args_unused) {
    extern __shared__ __attribute__((aligned(16))) unsigned char lds_raw[];
    LAS unsigned char* lds = (LAS unsigned char*)lds_raw;
    volatile LAS unsigned* MISC = (volatile LAS unsigned*)(lds + MISC_OFF);
    const int tid = threadIdx.x;
    const int G = gridDim.x;
    KAp ap = (KAp)__builtin_amdgcn_kernarg_segment_ptr();
    for (int u = tid; u < (LDS_BYTES - LDSCTL_OFF) / 4; u += NTHR) ((LAS unsigned*)(lds + LDSCTL_OFF))[u] = 0u;
    __syncthreads();
    XcdBarrier bar = xcd_barrier_post((unsigned*)(ap->ws + WS_CTL) + CW_BAR, MISC + 8);
#define GRID_BAR() xcd_barrier(bar)
#define WSP(off) (ap->ws + (off))

#ifndef SKIP_PRO
    phase_prologue(ap, lds, G, tid);
#endif
    GRID_BAR();
#ifndef SKIP_FILT
    phase_mod_filters(ap, lds, G, tid);
#endif
    GRID_BAR();
    phase_init(ap, G, tid);
    GRID_BAR();

#pragma unroll 1
    for (int l = 0; l < 4; ++l) {
        const int j = l >> 1;
#pragma unroll 1
        for (int half = 0; half < 2; ++half) {
            if (half == 1) {
                if ((l & 1) == 0) {
                    { LAUNDER_S(ap); EpiQKV E{(bf16*)WSP(WS_ACT), ap->out + (size_t)MROWS * D, ap->out + (size_t)MROWS * D + 2097152, j};
                      run_gemm(lds, (const bf16*)WSP(WS_HB), (const bf16*)WSP(WS_QKVT) + (size_t)j * NQKV * D, MROWS, NQKV, D, G, E); }
                    GRID_BAR();
#ifndef SKIP_ATTN
                    phase_attn(ap, j, lds, G, tid);
#endif
                    GRID_BAR();
                    { LAUNDER_S(ap); EpiF32 E{(float*)WSP(WS_F), D};
                      run_gemm(lds, (const bf16*)WSP(WS_HB), (const bf16*)WSP(WS_OT) + (size_t)j * D * D, MROWS, D, D, G, E); }
                    GRID_BAR();
                } else {
                    { LAUNDER_S(ap); pg8::EpiBf16<0> E{(bf16*)WSP(WS_ACT), MROWS, nullptr, 0, 0, 1.f};
                      run_gemm(lds, (const bf16*)WSP(WS_HIT) + (size_t)j * NHY * D, (const bf16*)WSP(WS_HB), NHY, MROWS, D, G, E); }
                    GRID_BAR();
#ifndef SKIP_HY
                    phase_hyena(ap, j, lds, G, tid);
#endif
                    GRID_BAR();
                    phase_transpose(ap, lds, G, tid);
                    GRID_BAR();
                    { LAUNDER_S(ap); EpiF32 E{(float*)WSP(WS_F), D};
                      run_gemm(lds, (const bf16*)WSP(WS_HB), (const bf16*)WSP(WS_HOT) + (size_t)j * D * D, MROWS, D, D, G, E); }
                    GRID_BAR();
                }
                phase_ln(ap, l, 5, 1.0f, l * 3 + 1, l, 6, false, G, tid);
                GRID_BAR();
            }
            { LAUNDER_S(ap); EpiSwiglu E{(bf16*)WSP(WS_ACT)};
              run_gemm(lds, (const bf16*)WSP(WS_HB), (const bf16*)WSP(WS_W1T) + (size_t)(l * 2 + half) * NFF1 * D, MROWS, NFF1, D, G, E); }
            GRID_BAR();
            { LAUNDER_S(ap); EpiF32 E{(float*)WSP(WS_F), D};
              run_gemm(lds, (const bf16*)WSP(WS_ACT), (const bf16*)WSP(WS_W2T) + (size_t)(l * 2 + half) * D * DFF, MROWS, D, DFF, G, E); }
            GRID_BAR();
            if (half == 0) phase_ln(ap, l, 2, 0.5f, l * 3 + 0, l, 3, false, G, tid);
            else phase_ln(ap, l, 8, 0.5f, l * 3 + 2, l < 3 ? l + 1 : -1, 0, l == 3, G, tid);
            if (!(l == 3 && half == 1)) GRID_BAR();
        }
    }
#undef GRID_BAR
#undef WSP
}

extern "C" void kernel_launch(void* const* d_in, const int* in_sizes, int n_in, void* d_out, int out_size, void* d_ws, size_t ws_size, hipStream_t stream) {
    static int grid = 0;
    if (grid == 0) {
        if (n_in != 25 || ws_size < WS_END) { fprintf(stderr, "kernel_launch: need 25 inputs and >= %zu bytes of workspace (got %d, %zu)\n", (size_t)WS_END, n_in, ws_size); grid = -1; return; }
        int dev = 0, cus = 0, per_cu = 0;
        if (hipGetDevice(&dev) != hipSuccess || hipDeviceGetAttribute(&cus, hipDeviceAttributeMultiprocessorCount, dev) != hipSuccess) { grid = -1; return; }
        if (hipFuncSetAttribute((const void*)fwd_megakernel, hipFuncAttributeMaxDynamicSharedMemorySize, LDS_BYTES) != hipSuccess) { fprintf(stderr, "kernel_launch: hipFuncSetAttribute failed\n"); grid = -1; return; }
        if (hipOccupancyMaxActiveBlocksPerMultiprocessor(&per_cu, (const void*)fwd_megakernel, NWAVES * 64, LDS_BYTES) != hipSuccess || per_cu < 1) { fprintf(stderr, "kernel_launch: occupancy query reports %d\n", per_cu); per_cu = 1; }
        (void)hipGetLastError();
        grid = cus;
    }
    if (grid < 0) return;
    (void)hipMemsetAsync((char*)d_ws + WS_CTL, 0, CTL_ZERO_BYTES, stream);
    KArgs a{};
    for (int i = 0; i < 25; ++i) a.in[i] = (const float*)d_in[i];
    a.out = (float*)d_out; a.ws = (unsigned char*)d_ws;
    void* kargs[] = {&a};
    hipError_t e = hipLaunchCooperativeKernel((const void*)fwd_megakernel, dim3(grid), dim3(NWAVES * 64), kargs, LDS_BYTES, stream);
    if (e != hipSuccess) { (void)hipGetLastError(); hipLaunchKernelGGL(fwd_megakernel, dim3(grid), dim3(NWAVES * 64), LDS_BYTES, stream, a); }
}
```
